# Optimizing an MI355X kernel written in HIP

```python
import math
import jax, jax.numpy as jnp
from jax import lax
import numpy as np

D_MODEL = 1024
BATCH = 8
SEQ = 2048
DEPTH = 1

MIX_WIDTH = D_MODEL
CONV_WIDTH = D_MODEL // 2
ATTN_WIDTH = MIX_WIDTH - CONV_WIDTH
N_DIFF_HEADS = 4
DIFF_HEAD_DIM = ATTN_WIDTH // (2 * N_DIFF_HEADS)
DIFF_V_DIM = 2 * DIFF_HEAD_DIM
CONV_KERNEL = 31
CONV_PAD = (CONV_KERNEL - 1) // 2
ROPE_THETA = 10000.0
Q_BLOCK = 128
EPS = 1e-6
LN_EPS = 1e-5
IN_COLS = 3 * CONV_WIDTH + 4 * ATTN_WIDTH

kernel_name = "hybrid_conformer_conv_diff_attn_parallel"


def lambda_init_fn(layer_idx):
    return 0.8 - 0.6 * math.exp(-0.3 * layer_idx)


def rmsnorm(x, g, eps=EPS):
    xf = x.astype(jnp.float32)
    y = xf * lax.rsqrt(jnp.mean(xf * xf, axis=-1, keepdims=True) + eps)
    return (y * g.astype(jnp.float32)).astype(x.dtype)


def layernorm(x, g, b, eps=LN_EPS):
    xf = x.astype(jnp.float32)
    mu = jnp.mean(xf, axis=-1, keepdims=True)
    var = jnp.mean(jnp.square(xf - mu), axis=-1, keepdims=True)
    y = (xf - mu) * lax.rsqrt(var + eps)
    return (y * g.astype(jnp.float32) + b.astype(jnp.float32)).astype(x.dtype)


def rope(t, seq_len):
    dh = t.shape[-1]
    half = dh // 2
    pos = jnp.arange(seq_len, dtype=jnp.float32)
    inv_freq = 1.0 / (ROPE_THETA ** (jnp.arange(half, dtype=jnp.float32) * 2.0 / dh))
    ang = pos[:, None] * inv_freq[None, :]
    ang = jnp.concatenate([ang, ang], axis=-1)
    cos = jnp.cos(ang)[None, :, None, :].astype(t.dtype)
    sin = jnp.sin(ang)[None, :, None, :].astype(t.dtype)
    t1, t2 = t[..., :half], t[..., half:]
    rot = jnp.concatenate([-t2, t1], axis=-1)
    return t * cos + rot * sin


def conformer_conv_branch(a_val, a_glu, conv_w, conv_b, ln_g, ln_b, w_pw, b_pw):
    u = a_val * jax.nn.sigmoid(a_glu)
    u = lax.conv_general_dilated(
        u, conv_w[:, None, :], window_strides=(1,),
        padding=[(CONV_PAD, CONV_PAD)],
        dimension_numbers=("NWC", "WIO", "NWC"),
        feature_group_count=CONV_WIDTH) + conv_b
    u = layernorm(u, ln_g, ln_b)
    u = jax.nn.silu(u)
    return jnp.einsum("bsc,ce->bse", u, w_pw) + b_pw


def diff_attention_branch(q, k, v, lq1, lk1, lq2, lk2, head_g, lam_init):
    b, s, _ = q.shape
    q = rope(q.reshape(b, s, 2 * N_DIFF_HEADS, DIFF_HEAD_DIM), s)
    k = rope(k.reshape(b, s, 2 * N_DIFF_HEADS, DIFF_HEAD_DIM), s)
    q = q.reshape(b, s, N_DIFF_HEADS, 2, DIFF_HEAD_DIM).transpose(3, 0, 2, 1, 4)
    k = k.reshape(b, s, N_DIFF_HEADS, 2, DIFF_HEAD_DIM).transpose(3, 0, 2, 1, 4)
    v = v.reshape(b, s, N_DIFF_HEADS, DIFF_V_DIM).transpose(0, 2, 1, 3)
    k1, k2 = k[0], k[1]
    lam = (jnp.exp(jnp.sum(lq1.astype(jnp.float32) * lk1.astype(jnp.float32)))
           - jnp.exp(jnp.sum(lq2.astype(jnp.float32) * lk2.astype(jnp.float32)))
           + lam_init)
    scale = DIFF_HEAD_DIM ** -0.5
    nb = s // Q_BLOCK
    qb = q.reshape(2, b, N_DIFF_HEADS, nb, Q_BLOCK, DIFF_HEAD_DIM).transpose(3, 0, 1, 2, 4, 5)

    def block(qblk):
        s1 = jnp.einsum("bhqd,bhkd->bhqk", qblk[0], k1).astype(jnp.float32) * scale
        s2 = jnp.einsum("bhqd,bhkd->bhqk", qblk[1], k2).astype(jnp.float32) * scale
        w = jax.nn.softmax(s1, axis=-1) - lam * jax.nn.softmax(s2, axis=-1)
        return jnp.einsum("bhqk,bhke->bhqe", w.astype(v.dtype), v)

    o = lax.map(block, qb)
    o = o.transpose(1, 3, 0, 2, 4).reshape(b, s, N_DIFF_HEADS, DIFF_V_DIM)
    o = rmsnorm(o, head_g) * jnp.asarray(1.0 - lam_init, dtype=o.dtype)
    return o.reshape(b, s, ATTN_WIDTH)


def setup_inputs(seed: int = 0) -> dict:
    key = jax.random.key(seed)
    ks = jax.random.split(key, 18)
    f32 = jnp.float32
    nrm = lambda k, shape, sc: jax.random.normal(k, shape, f32) * sc
    return {
        "x": nrm(ks[0], (BATCH, SEQ, D_MODEL), 1.0),
        "norm_g": 1.0 + nrm(ks[1], (DEPTH, D_MODEL), 0.02),
        "w_in": nrm(ks[2], (DEPTH, D_MODEL, IN_COLS), D_MODEL ** -0.5),
        "conv_w": nrm(ks[3], (DEPTH, CONV_KERNEL, CONV_WIDTH), CONV_KERNEL ** -0.5),
        "conv_b": nrm(ks[4], (DEPTH, CONV_WIDTH), 0.02),
        "conv_ln_g": 1.0 + nrm(ks[5], (DEPTH, CONV_WIDTH), 0.02),
        "conv_ln_b": nrm(ks[6], (DEPTH, CONV_WIDTH), 0.02),
        "w_pw": nrm(ks[7], (DEPTH, CONV_WIDTH, CONV_WIDTH), CONV_WIDTH ** -0.5),
        "b_pw": nrm(ks[8], (DEPTH, CONV_WIDTH), 0.02),
        "lambda_q1": nrm(ks[9], (DEPTH, DIFF_HEAD_DIM), 0.1),
        "lambda_k1": nrm(ks[10], (DEPTH, DIFF_HEAD_DIM), 0.1),
        "lambda_q2": nrm(ks[11], (DEPTH, DIFF_HEAD_DIM), 0.1),
        "lambda_k2": nrm(ks[12], (DEPTH, DIFF_HEAD_DIM), 0.1),
        "head_norm_g": 1.0 + nrm(ks[13], (DEPTH, DIFF_V_DIM), 0.02),
        "w_out": nrm(ks[14], (DEPTH, MIX_WIDTH, D_MODEL), MIX_WIDTH ** -0.5),
        "final_norm_g": 1.0 + nrm(ks[15], (D_MODEL,), 0.02),
    }


def reference(x, norm_g, w_in, conv_w, conv_b, conv_ln_g, conv_ln_b, w_pw, b_pw,
              lambda_q1, lambda_k1, lambda_q2, lambda_k2, head_norm_g, w_out,
              final_norm_g):
    C, A = CONV_WIDTH, ATTN_WIDTH
    for l in range(DEPTH):
        h = rmsnorm(x, norm_g[l])
        p = jnp.einsum("bsd,de->bse", h, w_in[l])
        a_val = p[..., 0:C]
        a_glu = p[..., C:2 * C]
        a_gate = p[..., 2 * C:3 * C]
        o = 3 * C
        q = p[..., o:o + A]
        k = p[..., o + A:o + 2 * A]
        v = p[..., o + 2 * A:o + 3 * A]
        b_gate = p[..., o + 3 * A:o + 4 * A]
        y_a = conformer_conv_branch(a_val, a_glu, conv_w[l], conv_b[l], conv_ln_g[l],
                                    conv_ln_b[l], w_pw[l], b_pw[l]) * jax.nn.silu(a_gate)
        y_b = diff_attention_branch(q, k, v, lambda_q1[l], lambda_k1[l], lambda_q2[l],
                                    lambda_k2[l], head_norm_g[l], lambda_init_fn(l)) * jax.nn.silu(b_gate)
        y = jnp.concatenate([y_a, y_b], axis=-1)
        x = x + jnp.einsum("bse,ed->bsd", y, w_out[l])
    return rmsnorm(x, final_norm_g)
```

```cpp
#include <hip/hip_runtime.h>
#include <hip/hip_cooperative_groups.h>
#include <cstdio>
#include <cstdint>
namespace cg = cooperative_groups;
#ifndef MK_N_LAUNCHES
#define MK_N_LAUNCHES 5
#endif
namespace pg8 {
#define PG8_LAS __attribute__((address_space(3)))
typedef unsigned short bf16_t;
typedef short bf16x8 __attribute__((ext_vector_type(8)));
typedef float f32x4 __attribute__((ext_vector_type(4)));
typedef unsigned u32x4 __attribute__((ext_vector_type(4)));
constexpr int BM = 256, BK = 64, HALF = 128, HTB = HALF * BK * 2  , STAGE_BYTES = 8 * HTB, NXCD = 8, WGM = 8;

__host__ __device__ __forceinline__ int lds_byte(int r, int c) { const int st = (r >> 4) * 2 + (c >> 5), rr = r & 15, cc = c & 31, ob = rr * 64 + cc * 2; return st * 1024 + (ob ^ (((ob >> 9) & 1) << 5)); }
__host__ __device__ __forceinline__ void stage_rc(int b, int& R, int& C) { const int st = b / 1024, sb = b % 1024, swz = sb ^ (((sb >> 9) & 1) << 5); R = (st >> 1) * 16 + swz / 64; C = (st & 1) * 32 + (swz % 64) / 2; }
__host__ __device__ __forceinline__ int perm32(int rho) { const int n = rho >> 4, i = rho & 15; return 8 * (i >> 2) + 4 * n + (i & 3); }

struct Unit { int pm, pn; };
struct Gemm { const bf16_t* A; const bf16_t* Bt; int M, N, K; };

struct StaticOrder {
    int nM, nN, nwg, G, c;
    __host__ __device__ void init(int M, int N, int G_, int c_) { nM = M / BM; nN = N / BM; nwg = nM * nN; G = G_; c = c_; }
    __host__ __device__ bool next(int i, Unit& u) const {
        const long L = (long)i * G + c; if (L >= nwg) return false;
        int wgid = (int)L; { const int q = nwg / NXCD, r = nwg % NXCD, xcd = wgid % NXCD, off = wgid / NXCD; wgid = (xcd < r ? xcd * (q + 1) : r * (q + 1) + (xcd - r) * q) + off; }
        const int nig = WGM * nN, gid = wgid / nig, fm = gid * WGM, gsz = (nM - fm) < WGM ? (nM - fm) : WGM;
        u.pm = fm + ((wgid % nig) % gsz); u.pn = (wgid % nig) / gsz; return true;
    }
    __device__ __forceinline__ void a_ready(const Unit&) const {}
    __device__ __forceinline__ void done(const Unit&) const {}
};

__device__ __forceinline__ unsigned cvt_pk_bf16(float lo, float hi) { unsigned r; asm volatile("v_cvt_pk_bf16_f32 %0, %1, %2" : "=v"(r) : "v"(lo), "v"(hi)); return r; }
typedef float f32x2 __attribute__((ext_vector_type(2)));
struct PanelStats {
    unsigned* xbuf;
    unsigned* cnt;
    unsigned* tmo;
    int ntn; float eps;
    unsigned code;
    __device__ __forceinline__ bool run(const f32x4 (&v)[2][2][4][2], const Unit& u, int wr, int wc, int fr, int fq, PG8_LAS unsigned char* lds, int wid, int lane) const {
        typedef float f32x2v __attribute__((ext_vector_type(2)));
        PG8_LAS f32x2v* P = (PG8_LAS f32x2v*)lds;
        PG8_LAS f32x2v* S = (PG8_LAS f32x2v*)(lds + 8192);
        PG8_LAS unsigned* flag = (PG8_LAS unsigned*)(lds + 8192 + 2048);
#pragma unroll
        for (int ai = 0; ai < 2; ++ai)
#pragma unroll
            for (int m = 0; m < 4; ++m) {
                float s = 0.f;
#pragma unroll
                for (int bj = 0; bj < 2; ++bj)
#pragma unroll
                    for (int n = 0; n < 2; ++n) { const f32x4 x = v[ai][bj][m][n]; s += (x[0] + x[1]) + (x[2] + x[3]); }
                s += __shfl_xor(s, 16); s += __shfl_xor(s, 32);
                const float mw = s * (1.0f / 64.0f); float q = 0.f;
#pragma unroll
                for (int bj = 0; bj < 2; ++bj)
#pragma unroll
                    for (int n = 0; n < 2; ++n) { const f32x4 d = v[ai][bj][m][n] - mw; q += (d[0] * d[0] + d[1] * d[1]) + (d[2] * d[2] + d[3] * d[3]); }
                q += __shfl_xor(q, 16); q += __shfl_xor(q, 32);
                if (fq == 0) P[(ai * HALF + wr * 64 + m * 16 + fr) * 4 + wc] = (f32x2v){mw, q};
            }
        asm volatile("s_waitcnt lgkmcnt(0)" ::: "memory"); __builtin_amdgcn_s_barrier(); asm volatile("" ::: "memory");
#if defined(BROKEN_EXCHANGE_NO_WAIT)
#warning BROKEN CONTROL BUILD: the row-statistics exchange does not wait; results are wrong by design
        if (blockIdx.x >= 64) { const long long t0_ = clock64(); while (clock64() - t0_ < 60000) __builtin_amdgcn_s_sleep(8); }
#endif
        const int row = wid * 32 + (lane & 31);
        if (lane < 32) {
            const f32x2v a = P[row * 4 + 0], b = P[row * 4 + 1], c = P[row * 4 + 2], d = P[row * 4 + 3];
            const float mt = (a.x + b.x + c.x + d.x) * 0.25f;
            const float da = a.x - mt, db = b.x - mt, dc = c.x - mt, dd = d.x - mt;
            const float m2 = (a.y + b.y) + (c.y + d.y) + 64.0f * ((da * da + db * db) + (dc * dc + dd * dd));
            unsigned long long* slot = (unsigned long long*)xbuf + ((size_t)(u.pm * BM + row) * 4 + u.pn);
            __hip_atomic_store(slot, ((unsigned long long)__float_as_uint(m2) << 32) | __float_as_uint(mt), __ATOMIC_RELAXED, __HIP_MEMORY_SCOPE_AGENT);
        }
        asm volatile("s_waitcnt vmcnt(0)" ::: "memory");
        if (lane == 0) __hip_atomic_fetch_add(cnt + 64 * u.pm, 1u, __ATOMIC_RELAXED, __HIP_MEMORY_SCOPE_AGENT);
        if (wid == 0) {
            bool dead = false; const unsigned long long t0 = __builtin_amdgcn_s_memrealtime(); const unsigned want = 8u * (unsigned)ntn;
            for (;;) {
#if defined(BROKEN_EXCHANGE_NO_WAIT)
                break;
#endif
                if ((unsigned)__builtin_amdgcn_readfirstlane(__hip_atomic_load(cnt + 64 * u.pm, __ATOMIC_RELAXED, __HIP_MEMORY_SCOPE_AGENT)) >= want) break;
                if (__builtin_amdgcn_s_memrealtime() - t0 > 2000000ull) {
                    if (lane == 0) { unsigned expect = 0u; __hip_atomic_compare_exchange_strong(tmo + 1, &expect, code | (unsigned)(u.pm & 0xff), __ATOMIC_RELAXED, __ATOMIC_RELAXED, __HIP_MEMORY_SCOPE_AGENT);
                                     __hip_atomic_store(tmo, 1u, __ATOMIC_RELAXED, __HIP_MEMORY_SCOPE_AGENT); }
                    dead = true; break; }
                __builtin_amdgcn_s_sleep(2);
            }
            __builtin_amdgcn_fence(__ATOMIC_ACQUIRE, "agent");
            if (lane == 0) flag[0] = dead ? 1u : 0u;
        }
        asm volatile("s_waitcnt vmcnt(0) lgkmcnt(0)" ::: "memory"); __builtin_amdgcn_s_barrier(); asm volatile("" ::: "memory");
        const bool bad = flag[0] != 0u;
        if (lane < 32) {
            const unsigned long long* slot = (const unsigned long long*)xbuf + (size_t)(u.pm * BM + row) * 4; float mt[4], m2[4]; float ms = 0.f;
#pragma unroll
            for (int t = 0; t < 4; ++t) { if (t < ntn) { const unsigned long long w = __hip_atomic_load(slot + t, __ATOMIC_RELAXED, __HIP_MEMORY_SCOPE_AGENT); mt[t] = __uint_as_float((unsigned)w); m2[t] = __uint_as_float((unsigned)(w >> 32)); } else { mt[t] = 0.f; m2[t] = 0.f; } ms += mt[t]; }
            const float mean = ms / (float)ntn; float q = 0.f;
#pragma unroll
            for (int t = 0; t < 4; ++t) if (t < ntn) { const float dm = mt[t] - mean; q += m2[t] + 256.0f * dm * dm; }
            S[row] = (f32x2v){mean, 1.0f / sqrtf(q / (256.0f * (float)ntn) + mean * mean + eps)};
        }
        asm volatile("s_waitcnt lgkmcnt(0)" ::: "memory"); __builtin_amdgcn_s_barrier(); asm volatile("" ::: "memory");
        return bad;
    }
};
template <class Epi, class Sched, bool ALIGN_EPI = false, bool SP2 = false>
__device__ __forceinline__ void gemm_phase(PG8_LAS unsigned char* lds, const Gemm g, const Sched& S, const Epi& E) {
    const int tid = threadIdx.x, wid = __builtin_amdgcn_readfirstlane(tid >> 6), lane = tid & 63, wr = wid >> 2, wc = wid & 3, fr = lane & 15, fq = lane >> 4;
    const int K = g.K, nt = K / BK;
    unsigned voffA[2], voffB[2];
#pragma unroll
    for (int i = 0; i < 2; ++i) { int R, C; stage_rc(tid * 16 + i * 8192, R, C); const int Rb = Epi::PERM ? ((R & ~31) + perm32(R & 31)) : R;
        voffA[i] = (unsigned)(R * K + C) * 2u; voffB[i] = (unsigned)(Rb * K + C) * 2u; }
    const size_t kstep = (size_t)(BK * 2);
    const size_t hstep = (size_t)HALF * K * 2;
    const size_t tstep = 2 * hstep;
    const unsigned ldsw = (unsigned)wid * 1024u;
    const int aoff = lds_byte(wr * 64 + fr, fq * 8), boff = lds_byte(wc * 32 + fr, fq * 8);
#define PG8_SA(b, h) (((b) * 2 + (h)) * HTB)
#define PG8_SB(b, h) ((4 + (b) * 2 + (h)) * HTB)
#define PG8_STAGE(bufoff, gbase, voff) do { _Pragma("unroll") for (int _i = 0; _i < 2; ++_i) \
        __builtin_amdgcn_global_load_lds((const unsigned*)((const char*)(gbase) + (voff)[_i]), (PG8_LAS unsigned*)(lds + (bufoff) + ldsw + _i * 8192), 16, 0, 0); } while (0)
#define PG8_LDA(dst, b, h) do { _Pragma("unroll") for (int m = 0; m < 4; ++m) _Pragma("unroll") for (int k = 0; k < 2; ++k) dst[m][k] = *(const PG8_LAS bf16x8*)(lds + PG8_SA(b, h) + aoff + m * 2048 + k * 1024); } while (0)
#define PG8_LDB(dst, b, h) do { _Pragma("unroll") for (int n = 0; n < 2; ++n) _Pragma("unroll") for (int k = 0; k < 2; ++k) dst[n][k] = *(const PG8_LAS bf16x8*)(lds + PG8_SB(b, h) + boff + n * 2048 + k * 1024); } while (0)
#define PG8_MMA(ai, bj, At, Bt) do { __builtin_amdgcn_s_setprio(1); _Pragma("unroll") for (int m = 0; m < 4; ++m) _Pragma("unroll") for (int n = 0; n < 2; ++n) _Pragma("unroll") for (int k = 0; k < 2; ++k) \
        acc[ai][bj][m][n] = __builtin_amdgcn_mfma_f32_16x16x32_bf16(Bt[n][k], At[m][k], acc[ai][bj][m][n], 0, 0, 0); __builtin_amdgcn_s_setprio(0); } while (0)
#define PG8_WAIT_V(n) asm volatile("s_waitcnt vmcnt(" #n ")" ::: "memory")
#define PG8_WAIT_L(n) asm volatile("s_waitcnt lgkmcnt(" #n ")" ::: "memory")
#define PG8_BAR __builtin_amdgcn_s_barrier()
#define PG8_SCHED __builtin_amdgcn_sched_barrier(0)
    Unit cur, nxt; int ui = 0;
    if (!S.next(0, cur)) return;
    f32x4 acc[2][2][4][2];
#pragma unroll
    for (int a = 0; a < 2; ++a)
#pragma unroll
        for (int b = 0; b < 2; ++b)
#pragma unroll
            for (int m = 0; m < 4; ++m)
#pragma unroll
                for (int n = 0; n < 2; ++n) acc[a][b][m][n] = (f32x4){0.f, 0.f, 0.f, 0.f};
    bf16x8 At[4][2], B0[2][2], B1[2][2];
    const char* cA = (const char*)g.A + (size_t)cur.pm * tstep; const char* cB = (const char*)g.Bt + (size_t)cur.pn * tstep;
    S.a_ready(cur);
    if constexpr (SP2) {
        PG8_STAGE(PG8_SB(0, 0), cB, voffB); PG8_STAGE(PG8_SB(0, 1), cB + hstep, voffB); PG8_STAGE(PG8_SA(0, 0), cA, voffA); PG8_STAGE(PG8_SA(0, 1), cA + hstep, voffA);
        if (wr == 1) PG8_BAR;
        PG8_WAIT_V(2); PG8_BAR;
        PG8_STAGE(PG8_SB(1, 0), cB + kstep, voffB); PG8_STAGE(PG8_SA(1, 0), cA + kstep, voffA); PG8_STAGE(PG8_SB(1, 1), cB + hstep + kstep, voffB);
        PG8_WAIT_V(6); PG8_BAR;
    } else {
        PG8_STAGE(PG8_SB(0, 0), cB, voffB); PG8_STAGE(PG8_SA(0, 0), cA, voffA); PG8_STAGE(PG8_SB(0, 1), cB + hstep, voffB); PG8_STAGE(PG8_SA(0, 1), cA + hstep, voffA);
        if (wr == 1) PG8_BAR;
        PG8_WAIT_V(4); PG8_BAR;
        PG8_STAGE(PG8_SB(1, 0), cB + kstep, voffB); PG8_STAGE(PG8_SA(1, 0), cA + kstep, voffA); PG8_STAGE(PG8_SB(1, 1), cB + hstep + kstep, voffB);
        PG8_WAIT_V(6); PG8_BAR;
    }
    for (;;) {
        const bool has_next = S.next(ui + 1, nxt);
        const char* nA = has_next ? (const char*)g.A + (size_t)nxt.pm * tstep : cA; const char* nB = has_next ? (const char*)g.Bt + (size_t)nxt.pn * tstep : cB;
        for (int t = 0; t < nt; t += 2) {
            const bool last = (t == nt - 2);
            const char* a1 = cA + (size_t)(t + 1) * kstep;
            const char* a2 = last ? nA : cA + (size_t)(t + 2) * kstep; const char* b2 = last ? nB : cB + (size_t)(t + 2) * kstep;
            const char* a3 = a2 + kstep; const char* b3 = b2 + kstep;
            if (last && has_next) S.a_ready(nxt);
            if constexpr (SP2) {
            PG8_LDB(B0, 0, 0); PG8_LDB(B1, 0, 1); PG8_SCHED; PG8_LDA(At, 0, 0); PG8_STAGE(PG8_SA(1, 1), a1 + hstep, voffA);
            PG8_WAIT_V(8); PG8_WAIT_L(0); PG8_BAR; PG8_MMA(0, 0, At, B0); PG8_MMA(0, 1, At, B1); PG8_BAR; PG8_SCHED;
            PG8_LDA(At, 0, 1); PG8_STAGE(PG8_SB(0, 0), b2, voffB); PG8_STAGE(PG8_SB(0, 1), b2 + hstep, voffB); PG8_STAGE(PG8_SA(0, 0), a2, voffA);
            PG8_WAIT_V(8); PG8_WAIT_L(0); PG8_BAR; PG8_MMA(1, 0, At, B0); PG8_MMA(1, 1, At, B1); PG8_BAR; PG8_SCHED;
            PG8_LDB(B0, 1, 0); PG8_LDB(B1, 1, 1); PG8_SCHED; PG8_LDA(At, 1, 0); PG8_STAGE(PG8_SA(0, 1), a2 + hstep, voffA);
            PG8_WAIT_V(8); PG8_WAIT_L(0); PG8_BAR; PG8_MMA(0, 0, At, B0); PG8_MMA(0, 1, At, B1); PG8_BAR; PG8_SCHED;
            PG8_LDA(At, 1, 1); PG8_STAGE(PG8_SB(1, 0), b3, voffB); PG8_STAGE(PG8_SB(1, 1), b3 + hstep, voffB); PG8_STAGE(PG8_SA(1, 0), a3, voffA);
            PG8_WAIT_V(8); PG8_WAIT_L(0); PG8_BAR; PG8_MMA(1, 0, At, B0); PG8_MMA(1, 1, At, B1); PG8_BAR; PG8_SCHED;
            } else {
            PG8_LDB(B0, 0, 0); PG8_SCHED; PG8_LDA(At, 0, 0); PG8_STAGE(PG8_SA(1, 1), a1 + hstep, voffA);
            PG8_WAIT_L(8); PG8_BAR; PG8_WAIT_L(0); PG8_MMA(0, 0, At, B0); PG8_BAR; PG8_SCHED;
            PG8_LDB(B1, 0, 1); PG8_STAGE(PG8_SB(0, 0), b2, voffB);
            PG8_BAR; PG8_WAIT_L(0); PG8_MMA(0, 1, At, B1); PG8_BAR;
            PG8_LDA(At, 0, 1); PG8_STAGE(PG8_SA(0, 0), a2, voffA);
            PG8_BAR; PG8_WAIT_L(0); PG8_MMA(1, 0, At, B0); PG8_BAR; PG8_SCHED;
            PG8_STAGE(PG8_SB(0, 1), b2 + hstep, voffB);
            PG8_WAIT_V(6); PG8_BAR; PG8_MMA(1, 1, At, B1); PG8_BAR;
            PG8_LDB(B0, 1, 0); PG8_SCHED; PG8_LDA(At, 1, 0); PG8_STAGE(PG8_SA(0, 1), a2 + hstep, voffA);
            PG8_WAIT_L(8); PG8_BAR; PG8_WAIT_L(0); PG8_MMA(0, 0, At, B0); PG8_BAR; PG8_SCHED;
            PG8_LDB(B1, 1, 1); PG8_STAGE(PG8_SB(1, 0), b3, voffB);
            PG8_BAR; PG8_WAIT_L(0); PG8_MMA(0, 1, At, B1); PG8_BAR;
            PG8_LDA(At, 1, 1); PG8_STAGE(PG8_SA(1, 0), a3, voffA);
            PG8_BAR; PG8_WAIT_L(0); PG8_MMA(1, 0, At, B0); PG8_BAR; PG8_SCHED;
            PG8_STAGE(PG8_SB(1, 1), b3 + hstep, voffB);
            PG8_WAIT_V(6); PG8_BAR; PG8_MMA(1, 1, At, B1); PG8_BAR;
            }
        }
        if constexpr (ALIGN_EPI) { if (wr == 0) PG8_BAR; }
        if constexpr (!Epi::AFTER_DRAIN) { E(acc, cur, wr, wc, fr, fq); S.done(cur); }
        if (!has_next) break;
#pragma unroll
        for (int a = 0; a < 2; ++a)
#pragma unroll
            for (int b = 0; b < 2; ++b)
#pragma unroll
                for (int m = 0; m < 4; ++m)
#pragma unroll
                    for (int n = 0; n < 2; ++n) acc[a][b][m][n] = (f32x4){0.f, 0.f, 0.f, 0.f};
        cur = nxt; cA = nA; cB = nB; ++ui;
        if constexpr (ALIGN_EPI) { if (wr == 1) PG8_BAR; }
    }
    PG8_WAIT_V(0);
    if constexpr (!ALIGN_EPI) { if (wr == 0) PG8_BAR; }
    PG8_BAR;
    if constexpr (Epi::AFTER_DRAIN) { E.fused(acc, cur, wr, wc, fr, fq, lds, wid, lane); S.done(cur); }
#undef PG8_SA
#undef PG8_SB
#undef PG8_STAGE
#undef PG8_LDA
#undef PG8_LDB
#undef PG8_MMA
#undef PG8_WAIT_V
#undef PG8_WAIT_L
#undef PG8_BAR
#undef PG8_SCHED
}
}

constexpr int BATCH = 8, SEQ = 2048, DM = 1024, M = BATCH * SEQ, NIN = 3584, CW = 512;
constexpr float EPS_RMS = 1e-6f, EPS_LN = 1e-5f;
constexpr float C2 = 0.125f * 1.4426950408889634f;
constexpr float LOG2E = 1.4426950408889634f;
constexpr int N_LAUNCHES = MK_N_LAUNCHES;

typedef unsigned short bf16;
typedef float f32x4 __attribute__((ext_vector_type(4)));
typedef float f32x16 __attribute__((ext_vector_type(16)));
typedef short bf16x8 __attribute__((ext_vector_type(8)));
typedef short s16x4 __attribute__((ext_vector_type(4)));
typedef unsigned u32x4 __attribute__((ext_vector_type(4)));
typedef unsigned u32x2 __attribute__((ext_vector_type(2)));
#define LAS __attribute__((address_space(3)))

constexpr size_t MiB = 1u << 20;
constexpr size_t WS_CTL = 0, CTL_ZERO_BYTES = 1 * MiB;
constexpr size_t WS_WIN = 2 * MiB, WS_WPW = 9 * MiB, WS_WOUT = 10 * MiB, WS_ROPE = 12 * MiB, WS_XCH = 13 * MiB;
constexpr size_t WS_XN = 16 * MiB, WS_U = 48 * MiB, WS_GA = 64 * MiB, WS_Q = 80 * MiB, WS_K = 96 * MiB, WS_V = 112 * MiB, WS_GB = 128 * MiB;
constexpr size_t WS_Y = 144 * MiB, WS_O1 = 176 * MiB, WS_END = 208 * MiB;
constexpr int CW_TMO = 0, CW_SEAM = 16384;
constexpr int LDS_BYTES = 147456;

__device__ __forceinline__ unsigned f2bf(float f) { unsigned u = __builtin_bit_cast(unsigned, f); return (u + 0x7fffu + ((u >> 16) & 1u)) >> 16; }
__device__ __forceinline__ unsigned pk2(float lo, float hi) { return pg8::cvt_pk_bf16(lo, hi); }
__device__ __forceinline__ float bf2f(unsigned short b) { return __builtin_bit_cast(float, (unsigned)b << 16); }
__device__ __forceinline__ float bflo(unsigned w) { return __builtin_bit_cast(float, w << 16); }
__device__ __forceinline__ float bfhi(unsigned w) { return __builtin_bit_cast(float, w & 0xffff0000u); }
__device__ __forceinline__ float sigmoidf_(float v) { return __builtin_amdgcn_rcpf(1.0f + __builtin_amdgcn_exp2f(-v * LOG2E)); }
template <int MASK> __device__ __forceinline__ float swz_xor(float v) { return __builtin_bit_cast(float, __builtin_amdgcn_ds_swizzle(__builtin_bit_cast(int, v), 0x1f | (MASK << 10))); }
__device__ __forceinline__ float half_sum(float v) {
    v += swz_xor<1>(v); v += swz_xor<2>(v); v += swz_xor<4>(v); v += swz_xor<8>(v); v += swz_xor<16>(v); return v;
}
__device__ __forceinline__ float wave_sum(float v) {
    v = half_sum(v);
    auto rr = __builtin_amdgcn_permlane32_swap(__float_as_uint(v), __float_as_uint(v), false, false);
    return __uint_as_float(rr[0]) + __uint_as_float(rr[1]);
}

struct EpiIn {
    static constexpr bool PERM = true, AFTER_DRAIN = false;
    bf16 *U, *GA, *Q, *K, *V, *GB; const float* ropec; const float* ropes;
    __device__ __forceinline__ void operator()(const pg8::f32x4 (&acc)[2][2][4][2], const pg8::Unit& u, int wr, int wc, int fr, int fq) const {
        const int row0 = u.pm * 256 + wr * 64 + fr, pn = u.pn, j0 = wc * 32 + 8 * fq;
        if (pn < 4) {
#pragma unroll
            for (int ai = 0; ai < 2; ++ai)
#pragma unroll
                for (int m = 0; m < 4; ++m) {
                    const size_t row = (size_t)(row0 + ai * 128 + m * 16);
                    const f32x4 v0 = acc[ai][0][m][0], v1 = acc[ai][0][m][1], g0 = acc[ai][1][m][0], g1 = acc[ai][1][m][1];
                    u32x4 w;
                    w.x = pk2(v0[0] * sigmoidf_(g0[0]), v0[1] * sigmoidf_(g0[1])); w.y = pk2(v0[2] * sigmoidf_(g0[2]), v0[3] * sigmoidf_(g0[3]));
                    w.z = pk2(v1[0] * sigmoidf_(g1[0]), v1[1] * sigmoidf_(g1[1])); w.w = pk2(v1[2] * sigmoidf_(g1[2]), v1[3] * sigmoidf_(g1[3]));
                    *(u32x4*)(U + row * CW + pn * 128 + j0) = w;
                }
        } else if (pn < 6 || pn >= 12) {
            bf16* dst = (pn < 6) ? GA : GB; const int cb = ((pn < 6) ? (pn - 4) : (pn - 12)) * 256 + j0;
#pragma unroll
            for (int ai = 0; ai < 2; ++ai)
#pragma unroll
                for (int m = 0; m < 4; ++m) {
                    const size_t row = (size_t)(row0 + ai * 128 + m * 16);
#pragma unroll
                    for (int bj = 0; bj < 2; ++bj) {
                        const f32x4 v0 = acc[ai][bj][m][0], v1 = acc[ai][bj][m][1];
                        u32x4 w;
                        w.x = pk2(v0[0] * sigmoidf_(v0[0]), v0[1] * sigmoidf_(v0[1])); w.y = pk2(v0[2] * sigmoidf_(v0[2]), v0[3] * sigmoidf_(v0[3]));
                        w.z = pk2(v1[0] * sigmoidf_(v1[0]), v1[1] * sigmoidf_(v1[1])); w.w = pk2(v1[2] * sigmoidf_(v1[2]), v1[3] * sigmoidf_(v1[3]));
                        *(u32x4*)(dst + row * CW + cb + bj * 128) = w;
                    }
                }
        } else if (pn < 10) {
            bf16* dst = (pn < 8) ? Q : K; const float sc = (pn < 8) ? C2 : 1.0f;
            const int col = ((pn & 1) * 4 + wc) * 64 + 8 * fq;
#pragma unroll
            for (int ai = 0; ai < 2; ++ai)
#pragma unroll
                for (int m = 0; m < 4; ++m) {
                    const int rowi = row0 + ai * 128 + m * 16; const size_t row = (size_t)rowi; const int pos = rowi & (SEQ - 1);
                    const f32x4 c0 = *(const f32x4*)(ropec + pos * 32 + 8 * fq), c1 = *(const f32x4*)(ropec + pos * 32 + 8 * fq + 4);
                    const f32x4 s0 = *(const f32x4*)(ropes + pos * 32 + 8 * fq), s1 = *(const f32x4*)(ropes + pos * 32 + 8 * fq + 4);
                    const f32x4 a0 = acc[ai][0][m][0], a1 = acc[ai][0][m][1], b0 = acc[ai][1][m][0], b1 = acc[ai][1][m][1];
                    const f32x4 o10 = (a0 * c0 - b0 * s0) * sc, o11 = (a1 * c1 - b1 * s1) * sc, o20 = (b0 * c0 + a0 * s0) * sc, o21 = (b1 * c1 + a1 * s1) * sc;
                    u32x4 w1, w2;
                    w1.x = pk2(o10[0], o10[1]); w1.y = pk2(o10[2], o10[3]); w1.z = pk2(o11[0], o11[1]); w1.w = pk2(o11[2], o11[3]);
                    w2.x = pk2(o20[0], o20[1]); w2.y = pk2(o20[2], o20[3]); w2.z = pk2(o21[0], o21[1]); w2.w = pk2(o21[2], o21[3]);
                    *(u32x4*)(dst + row * CW + col) = w1; *(u32x4*)(dst + row * CW + col + 32) = w2;
                }
        } else {
            const int cb = (pn - 10) * 256 + j0;
#pragma unroll
            for (int ai = 0; ai < 2; ++ai)
#pragma unroll
                for (int m = 0; m < 4; ++m) {
                    const size_t row = (size_t)(row0 + ai * 128 + m * 16);
#pragma unroll
                    for (int bj = 0; bj < 2; ++bj) {
                        const f32x4 v0 = acc[ai][bj][m][0], v1 = acc[ai][bj][m][1];
                        u32x4 w; w.x = pk2(v0[0], v0[1]); w.y = pk2(v0[2], v0[3]); w.z = pk2(v1[0], v1[1]); w.w = pk2(v1[2], v1[3]);
                        *(u32x4*)(V + row * CW + cb + bj * 128) = w;
                    }
                }
        }
    }
};
struct EpiOutPlain {
    static constexpr bool PERM = false, AFTER_DRAIN = false;
    const float* base; float* out;
    __device__ __forceinline__ void operator()(const pg8::f32x4 (&acc)[2][2][4][2], const pg8::Unit& u, int wr, int wc, int fr, int fq) const {
        const int col0 = u.pn * 256 + wc * 32 + 4 * fq;
#pragma unroll
        for (int ai = 0; ai < 2; ++ai)
#pragma unroll
            for (int m = 0; m < 4; ++m) { const size_t off = (size_t)(u.pm * 256 + ai * 128 + wr * 64 + m * 16 + fr) * DM + col0;
#pragma unroll
                for (int bj = 0; bj < 2; ++bj)
#pragma unroll
                    for (int n = 0; n < 2; ++n) { const f32x4 bs = *(const f32x4*)(base + off + bj * 128 + n * 16); *(f32x4*)(out + off + bj * 128 + n * 16) = bs + acc[ai][bj][m][n]; }
                asm volatile("" ::: "memory"); }
    }
};
struct EpiOutFused {
    static constexpr bool PERM = false, AFTER_DRAIN = true;
    const float* base; float* out; const float* g; pg8::PanelStats st;
    __device__ __forceinline__ void fused(pg8::f32x4 (&acc)[2][2][4][2], const pg8::Unit& u, int wr, int wc, int fr, int fq, PG8_LAS unsigned char* lds, int wid, int lane) const {
        typedef float f32x2v __attribute__((ext_vector_type(2)));
        const PG8_LAS f32x2v* S = (const PG8_LAS f32x2v*)(lds + 8192);
        const int col0 = u.pn * 256 + wc * 32 + 4 * fq;
#pragma unroll
        for (int ai = 0; ai < 2; ++ai)
#pragma unroll
            for (int m = 0; m < 4; ++m) { const size_t off = (size_t)(u.pm * 256 + ai * 128 + wr * 64 + m * 16 + fr) * DM + col0;
#pragma unroll
                for (int bj = 0; bj < 2; ++bj)
#pragma unroll
                    for (int n = 0; n < 2; ++n) acc[ai][bj][m][n] += *(const f32x4*)(base + off + bj * 128 + n * 16);
                asm volatile("" : "+v"(acc[ai][0][m][0]), "+v"(acc[ai][0][m][1]), "+v"(acc[ai][1][m][0]), "+v"(acc[ai][1][m][1]));
                if (m & 1) asm volatile("" ::: "memory"); }
        const bool bad = st.run(acc, u, wr, wc, fr, fq, lds, wid, lane);
        const float qnan = __builtin_nanf("");
        pg8::f32x4 gv[2][2];
#pragma unroll
        for (int bj = 0; bj < 2; ++bj)
#pragma unroll
            for (int n = 0; n < 2; ++n) gv[bj][n] = *(const f32x4*)(g + col0 + bj * 128 + n * 16);
#pragma unroll
        for (int ai = 0; ai < 2; ++ai)
#pragma unroll
            for (int m = 0; m < 4; ++m) { const int r = ai * 128 + wr * 64 + m * 16 + fr; const f32x2v sr = S[r]; const size_t off = (size_t)(u.pm * 256 + r) * DM + col0;
#pragma unroll
                for (int bj = 0; bj < 2; ++bj)
#pragma unroll
                    for (int n = 0; n < 2; ++n) { f32x4 o = acc[ai][bj][m][n] * sr.y * gv[bj][n]; if (bad) o = (f32x4){qnan, qnan, qnan, qnan}; *(f32x4*)(out + off + bj * 128 + n * 16) = o; } }
    }
};

namespace att {
constexpr int KVBLK = 64, SHM_V = KVBLK * 128 * 2, SHM_K = KVBLK * 64 * 2, LD = CW;
constexpr float THR = 8.f;
#define KSWZ(row, colB) ((row) * 128 + ((colB) ^ ((((row) >> 1) & 7) << 4)))
#define SBAR() __builtin_amdgcn_sched_barrier(0)
__device__ __forceinline__ int crow(int r, int hi) { return (r & 3) + 8 * (r >> 2) + 4 * hi; }
__device__ __forceinline__ unsigned cvtpk(float lo, float hi) { unsigned r; asm volatile("v_cvt_pk_bf16_f32 %0, %1, %2" : "=v"(r) : "v"(lo), "v"(hi)); return r; }
__device__ __forceinline__ void partialSM(f32x16& p0, f32x16& p1, float& m_reg, float& mn, float& alpha) {
    float pmax = p0[0];
#pragma unroll
    for (int r = 1; r < 16; ++r) pmax = fmaxf(pmax, p0[r]);
#pragma unroll
    for (int r = 0; r < 16; ++r) pmax = fmaxf(pmax, p1[r]);
    { auto rr = __builtin_amdgcn_permlane32_swap(__float_as_uint(pmax), __float_as_uint(pmax), false, false);
      pmax = fmaxf(__uint_as_float(rr[0]), __uint_as_float(rr[1])); }
    if (__builtin_expect(__all(pmax - m_reg <= THR), 1)) { mn = m_reg; alpha = 1.f; }
    else { mn = fmaxf(m_reg, pmax); alpha = __builtin_amdgcn_exp2f(m_reg - mn); m_reg = mn; }
#pragma unroll
    for (int r = 0; r < 16; ++r) p0[r] = p0[r] - mn;
#pragma unroll
    for (int r = 0; r < 16; ++r) p1[r] = p1[r] - mn;
#pragma unroll
    for (int r = 0; r < 16; ++r) p0[r] = __builtin_amdgcn_exp2f(p0[r]);
}
__device__ __forceinline__ void finishSM(f32x16& p0, f32x16& p1, float alpha, float& l_reg, bf16x8& pa0, bf16x8& pa1, bf16x8& pa2, bf16x8& pa3) {
#pragma unroll
    for (int r = 0; r < 16; ++r) p1[r] = __builtin_amdgcn_exp2f(p1[r]);
    float ps = 0;
#pragma unroll
    for (int r = 0; r < 16; ++r) ps += p0[r];
#pragma unroll
    for (int r = 0; r < 16; ++r) ps += p1[r];
    { auto rr = __builtin_amdgcn_permlane32_swap(__float_as_uint(ps), __float_as_uint(ps), false, false);
      ps = __uint_as_float(rr[0]) + __uint_as_float(rr[1]); }
    l_reg = l_reg * alpha + ps;
#define PK4(P, BASE, OUT) do { unsigned a0 = cvtpk(P[BASE + 0], P[BASE + 1]), a1 = cvtpk(P[BASE + 2], P[BASE + 3]);   \
    unsigned b0 = cvtpk(P[BASE + 4], P[BASE + 5]), b1 = cvtpk(P[BASE + 6], P[BASE + 7]);                              \
    auto r0 = __builtin_amdgcn_permlane32_swap(a0, b0, false, false); auto r1 = __builtin_amdgcn_permlane32_swap(a1, b1, false, false); \
    u32x4 w = {r0[0], r1[0], r0[1], r1[1]}; OUT = *reinterpret_cast<bf16x8*>(&w); } while (0)
    PK4(p0, 0, pa0); PK4(p0, 8, pa1); PK4(p1, 0, pa2); PK4(p1, 8, pa3);
#undef PK4
}
__device__ __forceinline__ void qkt(f32x16& p0, f32x16& p1, const char* Ks, const bf16x8* qr, int r32, int hi) {
    p0 = f32x16{}; p1 = f32x16{};
#pragma unroll
    for (int d0 = 0; d0 < 4; ++d0) { const int cb = (d0 * 16 + hi * 8) * 2;
        const bf16x8 b0 = *reinterpret_cast<const bf16x8*>(Ks + KSWZ(r32, cb));
        const bf16x8 b1 = *reinterpret_cast<const bf16x8*>(Ks + KSWZ(32 + r32, cb));
        p0 = __builtin_amdgcn_mfma_f32_32x32x16_bf16(b0, qr[d0], p0, 0, 0, 0);
        p1 = __builtin_amdgcn_mfma_f32_32x32x16_bf16(b1, qr[d0], p1, 0, 0, 0); }
}
__device__ __forceinline__ int v_st(int k, int c) { const int kk = (k & ~0xC) | ((k & 4) << 1) | ((k & 8) >> 1); return ((kk >> 3) * 4 + (c >> 5)) * 512 + ((kk & 7) * 32 + (c & 31)) * 2; }
__device__ __forceinline__ int v_rd_base(int lane) { return ((lane & 3) << 3) | (((lane >> 2) & 3) << 6) | (((lane >> 4) & 1) << 5) | (((lane >> 5) & 1) << 8); }
constexpr int v_rd_off(int d0, int ks, int half) { return d0 * 512 + ks * 4096 + half * 2048; }
template <int OFF> __device__ __forceinline__ s16x4 tr_read(int vb) {
    s16x4 r; asm volatile("ds_read_b64_tr_b16 %0, %1 offset:%2" : "=&v"(r) : "v"(vb), "i"(OFF) : "memory"); return r;
}
template <int D0> __device__ __forceinline__ void pv_one(f32x16& od, int vb, bf16x8 pa0, bf16x8 pa1, bf16x8 pa2, bf16x8 pa3) {
    const s16x4 l0 = tr_read<v_rd_off(D0, 0, 0)>(vb), h0 = tr_read<v_rd_off(D0, 0, 1)>(vb), l1 = tr_read<v_rd_off(D0, 1, 0)>(vb), h1 = tr_read<v_rd_off(D0, 1, 1)>(vb);
    const s16x4 l2 = tr_read<v_rd_off(D0, 2, 0)>(vb), h2 = tr_read<v_rd_off(D0, 2, 1)>(vb), l3 = tr_read<v_rd_off(D0, 3, 0)>(vb), h3 = tr_read<v_rd_off(D0, 3, 1)>(vb);
    asm volatile("s_waitcnt lgkmcnt(0)" ::: "memory"); SBAR();
#define PK(L, H) (bf16x8){L[0], L[1], L[2], L[3], H[0], H[1], H[2], H[3]}
    od = __builtin_amdgcn_mfma_f32_32x32x16_bf16(pa0, PK(l0, h0), od, 0, 0, 0);
    od = __builtin_amdgcn_mfma_f32_32x32x16_bf16(pa1, PK(l1, h1), od, 0, 0, 0);
    od = __builtin_amdgcn_mfma_f32_32x32x16_bf16(pa2, PK(l2, h2), od, 0, 0, 0);
    od = __builtin_amdgcn_mfma_f32_32x32x16_bf16(pa3, PK(l3, h3), od, 0, 0, 0);
#undef PK
}
__device__ __forceinline__ void pv_d0(f32x16* o, int vb, bf16x8 pa0, bf16x8 pa1, bf16x8 pa2, bf16x8 pa3) {
    pv_one<0>(o[0], vb, pa0, pa1, pa2, pa3); pv_one<1>(o[1], vb, pa0, pa1, pa2, pa3); pv_one<2>(o[2], vb, pa0, pa1, pa2, pa3); pv_one<3>(o[3], vb, pa0, pa1, pa2, pa3);
}
__device__ __forceinline__ void body(const bf16* __restrict__ Qw, const char* __restrict__ Kg, const char* __restrict__ Vg, f32x16 (&o)[4], char* lds) {
    const int tid = threadIdx.x, wid = tid >> 6, lane = tid & 63, r32 = lane & 31, hi = lane >> 5;
    char* V_lds = lds; char* K_lds = lds + 2 * SHM_V;
    float* ws = (float*)(lds + 2 * SHM_V + 2 * SHM_K) + wid * 64; float* li_l = ws; float* al_l = ws + 32;
    float m_reg = -1e30f, l_reg = 0; bf16x8 qr[4];
#pragma unroll
    for (int d = 0; d < 4; ++d) o[d] = f32x16{};
#pragma unroll
    for (int d0 = 0; d0 < 4; ++d0) qr[d0] = *reinterpret_cast<const bf16x8*>(Qw + d0 * 16);
    const int sr = tid >> 4, sc = (tid & 15) * 8, vst0 = v_st(sr, sc), vst1 = v_st(32 + sr, sc);
    const int kr = tid >> 3, kc = (tid & 7) * 8, kst = KSWZ(kr, kc * 2);
    const int vb0 = (int)(uintptr_t)V_lds + v_rd_base(lane);
    bf16x8 svs0[2], svs1[2], sks[2];
    const unsigned voffV = (unsigned)(sr * LD + sc) * 2u, voffK = (unsigned)(kr * LD + kc) * 2u;
#define SLOAD(i, k0) do { const char* vt_ = Vg + (size_t)(k0) * (LD * 2); const char* kt_ = Kg + (size_t)(k0) * (LD * 2); \
    svs0[i] = *reinterpret_cast<const bf16x8*>(vt_ + voffV); svs1[i] = *reinterpret_cast<const bf16x8*>(vt_ + 32 * LD * 2 + voffV); \
    sks[i] = *reinterpret_cast<const bf16x8*>(kt_ + voffK); } while (0)
#define SWRITE(b, i) do { *(bf16x8*)(V_lds + (b) * SHM_V + vst0) = svs0[i]; *(bf16x8*)(V_lds + (b) * SHM_V + vst1) = svs1[i]; *(bf16x8*)(K_lds + (b) * SHM_K + kst) = sks[i]; } while (0)
#define SWAIT() asm volatile("s_waitcnt vmcnt(3)" ::: "memory")
#define RESC(a) do { if (__any((a) < 1.f)) { if (hi == 0) al_l[r32] = (a); asm volatile("s_waitcnt lgkmcnt(0)" ::: "memory"); \
    _Pragma("unroll") for (int d = 0; d < 4; ++d) _Pragma("unroll") for (int r = 0; r < 16; ++r) o[d][r] *= al_l[crow(r, hi)]; } } while (0)
    f32x16 pA0, pA1, pB0, pB1; float mnA, mnB, alA, alB; bf16x8 pa0, pa1, pa2, pa3; constexpr int NT = SEQ / KVBLK;
    __syncthreads();
    SLOAD(0, 0); asm volatile("s_waitcnt vmcnt(0)" ::: "memory"); SWRITE(0, 0); __syncthreads();
    qkt(pA0, pA1, K_lds, qr, r32, hi); partialSM(pA0, pA1, m_reg, mnA, alA);
    SLOAD(1, KVBLK); SLOAD(0, 2 * KVBLK);
    SWAIT(); SWRITE(1, 1); __syncthreads();
    for (int j = 1; j + 1 < NT; j += 2) {
        SBAR(); qkt(pB0, pB1, K_lds + SHM_K, qr, r32, hi);
        finishSM(pA0, pA1, alA, l_reg, pa0, pa1, pa2, pa3); SBAR();
        SLOAD(1, (j + 2) * KVBLK); SBAR();
        pv_d0(o, vb0, pa0, pa1, pa2, pa3); partialSM(pB0, pB1, m_reg, mnB, alB);
        __syncthreads(); SWAIT(); SWRITE(0, 0);
        RESC(alB); __syncthreads();
        SBAR(); qkt(pA0, pA1, K_lds, qr, r32, hi);
        finishSM(pB0, pB1, alB, l_reg, pa0, pa1, pa2, pa3); SBAR();
        if (j + 3 < NT) SLOAD(0, (j + 3) * KVBLK); SBAR();
        pv_d0(o, vb0 + SHM_V, pa0, pa1, pa2, pa3); partialSM(pA0, pA1, m_reg, mnA, alA);
        __syncthreads(); SWAIT(); SWRITE(1, 1);
        RESC(alA); __syncthreads();
    }
    SBAR(); qkt(pB0, pB1, K_lds + SHM_K, qr, r32, hi);
    finishSM(pA0, pA1, alA, l_reg, pa0, pa1, pa2, pa3); SBAR();
    pv_d0(o, vb0, pa0, pa1, pa2, pa3); partialSM(pB0, pB1, m_reg, mnB, alB);
    __syncthreads(); RESC(alB);
    finishSM(pB0, pB1, alB, l_reg, pa0, pa1, pa2, pa3); SBAR();
    pv_d0(o, vb0 + SHM_V, pa0, pa1, pa2, pa3);
    if (hi == 0) li_l[r32] = l_reg; asm volatile("s_waitcnt lgkmcnt(0)" ::: "memory");
#pragma unroll
    for (int r = 0; r < 16; ++r) { const float rl = __builtin_amdgcn_rcpf(li_l[crow(r, hi)]);
#pragma unroll
        for (int d = 0; d < 4; ++d) o[d][r] *= rl; }
#undef SLOAD
#undef SWRITE
#undef SWAIT
#undef RESC
}
__device__ __forceinline__ void unit(int un, const bf16* Q, const bf16* K, const bf16* V, const bf16* GB, bf16* Y, float* O1, const float* head_g, float lam, char* lds) {
    const int tid = threadIdx.x, wid = tid >> 6, lane = tid & 63, r32 = lane & 31, hi = lane >> 5;
    const int b = un >> 5, h = (un >> 3) & 3, qb = un & 7;
    const long rowb = (long)b * SEQ, q0 = rowb + qb * 256 + wid * 32;
    f32x16 o[4];
    const char* Vg = (const char*)(V + rowb * LD + h * 128);
#pragma unroll 1
    for (int mp = 0; mp < 2; ++mp) {
        { int t_ = threadIdx.x; asm volatile("" : "+v"(t_));
          const bf16* Qw = Q + (rowb + qb * 256 + (t_ >> 6) * 32 + (t_ & 31)) * LD + (2 * h + mp) * 64 + ((t_ >> 5) & 1) * 8;
          body(Qw, (const char*)(K + rowb * LD + (2 * h + mp) * 64), Vg, o, lds); }
        if (mp == 0) {
            int t_ = threadIdx.x; asm volatile("" : "+v"(t_));
            f32x4* o1p = (f32x4*)O1 + (size_t)un * 16 * 512 + t_;
#pragma unroll
            for (int d = 0; d < 4; ++d)
#pragma unroll
                for (int q = 0; q < 4; ++q) o1p[(d * 4 + q) * 512] = (f32x4){o[d][4 * q], o[d][4 * q + 1], o[d][4 * q + 2], o[d][4 * q + 3]};
        }
    }
    { int t_ = threadIdx.x; asm volatile("" : "+v"(t_));
      const f32x4* o1p = (const f32x4*)O1 + (size_t)un * 16 * 512 + t_;
#pragma unroll
      for (int d = 0; d < 4; ++d)
#pragma unroll
        for (int q = 0; q < 4; ++q) { const f32x4 a = o1p[(d * 4 + q) * 512];
#pragma unroll
            for (int i = 0; i < 4; ++i) o[d][4 * q + i] = a[i] - lam * o[d][4 * q + i]; } }
    int tid2 = threadIdx.x; asm volatile("" : "+v"(tid2));
    const int r32e = tid2 & 31, hie = (tid2 >> 5) & 1; const long q0e = rowb + qb * 256 + (tid2 >> 6) * 32;
    float gsc[4];
#pragma unroll
    for (int d = 0; d < 4; ++d) gsc[d] = head_g[d * 32 + r32e] * 0.8f;
#pragma unroll
    for (int r = 0; r < 16; ++r) {
        float ss = o[0][r] * o[0][r] + o[1][r] * o[1][r] + o[2][r] * o[2][r] + o[3][r] * o[3][r];
        ss = half_sum(ss);
        const float rstd = __builtin_amdgcn_rsqf(ss * (1.0f / 128.0f) + EPS_RMS);
        const int pq = qb * 256 + (tid2 >> 6) * 32 + crow(r, hie);
        const long row = rowb + ((pq & 127) * 16 + (pq >> 7));
#pragma unroll
        for (int d = 0; d < 4; ++d) { const int col = h * 128 + d * 32 + r32e;
            const float gate = bf2f(GB[row * CW + col]);
            Y[row * DM + CW + col] = (bf16)f2bf(o[d][r] * rstd * gsc[d] * gate); }
    }
}
#undef KSWZ
#undef SBAR
}


#ifdef DBG_NAIVE_ATTN
__device__ __forceinline__ float half_max(float v) { v = fmaxf(v, swz_xor<1>(v)); v = fmaxf(v, swz_xor<2>(v)); v = fmaxf(v, swz_xor<4>(v)); v = fmaxf(v, swz_xor<8>(v)); v = fmaxf(v, swz_xor<16>(v)); return v; }
__device__ __forceinline__ float wave_max(float v) { v = half_max(v); auto rr = __builtin_amdgcn_permlane32_swap(__float_as_uint(v), __float_as_uint(v), false, false); return fmaxf(__uint_as_float(rr[0]), __uint_as_float(rr[1])); }
__device__ __forceinline__ void naive_attn(int bx, int G, const bf16* Q, const bf16* K, const bf16* V, const bf16* GB, bf16* Y, const float* head_g, float lam, char* lds) {
    const int tid = threadIdx.x, wid = tid >> 6, lane = tid & 63;
    float* wbuf = (float*)lds + wid * 2048;
    for (int item = bx * 8 + wid; item < M * 4; item += G * 8) {
        int it2 = item; asm volatile("" : "+v"(it2)); const int row = it2 >> 2, h = it2 & 3; const long rowb = (long)(row >> 11) * SEQ;
#pragma unroll 1
        for (int mp = 0; mp < 2; ++mp) {
            const bf16* qp = Q + (long)row * CW + (2 * h + mp) * 64;
            float qv[64];
#pragma unroll
            for (int d = 0; d < 64; ++d) qv[d] = bf2f(qp[d]);
            float s[32]; float mx = -1e30f;
#pragma unroll
            for (int jj = 0; jj < 32; ++jj) { const bf16* kp = K + (rowb + jj * 64 + lane) * CW + (2 * h + mp) * 64; float a = 0.f;
#pragma unroll
                for (int c = 0; c < 8; ++c) { const u32x4 kw = *(const u32x4*)(kp + c * 8);
                    a += qv[c * 8 + 0] * bflo(kw.x) + qv[c * 8 + 1] * bfhi(kw.x) + qv[c * 8 + 2] * bflo(kw.y) + qv[c * 8 + 3] * bfhi(kw.y)
                       + qv[c * 8 + 4] * bflo(kw.z) + qv[c * 8 + 5] * bfhi(kw.z) + qv[c * 8 + 6] * bflo(kw.w) + qv[c * 8 + 7] * bfhi(kw.w); }
                s[jj] = a; mx = fmaxf(mx, a); }
            mx = wave_max(mx); float sum = 0.f;
#pragma unroll
            for (int jj = 0; jj < 32; ++jj) { s[jj] = __builtin_amdgcn_exp2f(s[jj] - mx); sum += s[jj]; }
            sum = wave_sum(sum); const float inv = 1.0f / sum;
#pragma unroll
            for (int jj = 0; jj < 32; ++jj) { const float w = s[jj] * inv; wbuf[jj * 64 + lane] = (mp == 0) ? w : (wbuf[jj * 64 + lane] - lam * w); }
        }
        asm volatile("s_waitcnt lgkmcnt(0)" ::: "memory");
        float o0 = 0.f, o1 = 0.f;
        for (int j = 0; j < SEQ; ++j) { const float w = wbuf[j]; const unsigned vw = *(const unsigned*)(V + (rowb + j) * CW + h * 128 + 2 * lane); o0 += w * bflo(vw); o1 += w * bfhi(vw); }
        const float ss = wave_sum(o0 * o0 + o1 * o1); const float rstd = __builtin_amdgcn_rsqf(ss * (1.0f / 128.0f) + EPS_RMS);
        int t2 = threadIdx.x; asm volatile("" : "+v"(t2)); const int l2 = t2 & 63;
        const int pq = row & (SEQ - 1); const long orow = rowb + ((pq & 127) * 16 + (pq >> 7));
        const unsigned gw = *(const unsigned*)(GB + orow * CW + h * 128 + 2 * l2);
        *(unsigned*)(Y + orow * DM + CW + h * 128 + 2 * l2) = pk2(o0 * rstd * head_g[2 * l2] * 0.8f * bflo(gw), o1 * rstd * head_g[2 * l2 + 1] * 0.8f * bfhi(gw));
        asm volatile("s_waitcnt lgkmcnt(0)" ::: "memory");
    }
}
#endif

__device__ __forceinline__ void conv_unit(int un, const bf16* U, const bf16* GA, const float* conv_w, const float* conv_b, const float* ln_g, const float* ln_b,
                                          const bf16* WpwT, const float* b_pw, bf16* Y, char* lds) {
    const int tid = threadIdx.x, wid = tid >> 6, lane = tid & 63, r32 = lane & 31, hi = lane >> 5;
    const int b = un >> 6, t0 = (un & 63) * 32; const long rowb = (long)b * SEQ;
    float* cf = (float*)lds;
    char* At = lds + 65536;
    __syncthreads();
    {
        const int c = tid;
        float w[31];
#pragma unroll
        for (int j = 0; j < 31; ++j) w[j] = conv_w[j * CW + c];
        float xin[62];
#pragma unroll
        for (int i = 0; i < 62; ++i) { const int t = t0 - 15 + i; const bool ok = (unsigned)t < (unsigned)SEQ; const int tc = ok ? t : t0;
            const float v = bf2f(U[(rowb + tc) * CW + c]); xin[i] = ok ? v : 0.f; }
        const float bias = conv_b[c];
#pragma unroll
        for (int tt = 0; tt < 32; ++tt) { float a = bias;
#pragma unroll
            for (int j = 0; j < 31; ++j) a = fmaf(xin[tt + j], w[j], a);
            cf[tt * CW + c] = a; }
    }
    __syncthreads();
    {
        const f32x4 g0 = *(const f32x4*)(ln_g + lane * 8), g1 = *(const f32x4*)(ln_g + lane * 8 + 4), b0 = *(const f32x4*)(ln_b + lane * 8), b1 = *(const f32x4*)(ln_b + lane * 8 + 4);
#pragma unroll
        for (int tk = 0; tk < 4; ++tk) { const int row = wid * 4 + tk;
            const f32x4 a0 = *(const f32x4*)(cf + row * CW + lane * 8), a1 = *(const f32x4*)(cf + row * CW + lane * 8 + 4);
            const float mean = wave_sum((a0[0] + a0[1]) + (a0[2] + a0[3]) + (a1[0] + a1[1]) + (a1[2] + a1[3])) * (1.0f / CW);
            const f32x4 d0 = a0 - mean, d1 = a1 - mean;
            const float var = wave_sum((d0[0] * d0[0] + d0[1] * d0[1]) + (d0[2] * d0[2] + d0[3] * d0[3]) + (d1[0] * d1[0] + d1[1] * d1[1]) + (d1[2] * d1[2] + d1[3] * d1[3])) * (1.0f / CW);
            const float rstd = __builtin_amdgcn_rsqf(var + EPS_LN);
            f32x4 y0 = d0 * rstd * g0 + b0, y1 = d1 * rstd * g1 + b1;
#pragma unroll
            for (int i = 0; i < 4; ++i) { y0[i] *= sigmoidf_(y0[i]); y1[i] *= sigmoidf_(y1[i]); }
            u32x4 pw; pw.x = pk2(y0[0], y0[1]); pw.y = pk2(y0[2], y0[3]); pw.z = pk2(y1[0], y1[1]); pw.w = pk2(y1[2], y1[3]);
            *(u32x4*)(At + row * 1024 + ((lane ^ (row & 15)) << 4)) = pw; }
    }
    __syncthreads();
    f32x16 acc[2]; acc[0] = f32x16{}; acc[1] = f32x16{};
    const bf16* wp = WpwT + (size_t)(wid * 64 + r32) * CW + hi * 8;
#pragma unroll 8
    for (int ks = 0; ks < 32; ++ks) {
        const bf16x8 a0 = *reinterpret_cast<const bf16x8*>(wp + ks * 16), a1 = *reinterpret_cast<const bf16x8*>(wp + 32 * CW + ks * 16);
        const int chunk = ks * 2 + hi;
        const bf16x8 bt = *reinterpret_cast<const bf16x8*>(At + r32 * 1024 + ((chunk ^ (r32 & 15)) << 4));
        acc[0] = __builtin_amdgcn_mfma_f32_32x32x16_bf16(a0, bt, acc[0], 0, 0, 0);
        acc[1] = __builtin_amdgcn_mfma_f32_32x32x16_bf16(a1, bt, acc[1], 0, 0, 0);
    }
    const long row = rowb + t0 + r32;
#pragma unroll
    for (int nb = 0; nb < 2; ++nb)
#pragma unroll
        for (int rq = 0; rq < 4; ++rq) { const int n = wid * 64 + nb * 32 + 8 * rq + 4 * hi;
            const f32x4 bp = *(const f32x4*)(b_pw + n); const u32x2 gw = *(const u32x2*)(GA + row * CW + n);
            u32x2 ow; ow.x = pk2((acc[nb][4 * rq] + bp[0]) * bflo(gw.x), (acc[nb][4 * rq + 1] + bp[1]) * bfhi(gw.x));
            ow.y = pk2((acc[nb][4 * rq + 2] + bp[2]) * bflo(gw.y), (acc[nb][4 * rq + 3] + bp[3]) * bfhi(gw.y));
            *(u32x2*)(Y + row * DM + n) = ow; }
}

__device__ __forceinline__ int src_col32(int n0) {
    const int pn = n0 >> 8, bj = (n0 >> 7) & 1, wc = (n0 >> 5) & 3;
    if (pn < 4) return bj * 512 + 128 * pn + 32 * wc;
    if (pn >= 6 && pn < 10) return 256 * pn + 64 * wc + 32 * bj;
    return n0;
}
__device__ __forceinline__ void transpose_item(const float* W, int K, int N, bf16* WT, bool perm, LAS float* scr, int item, int lane) {
    const int nblk = N / 32, kb = item / nblk, nb = item % nblk, k0 = 64 * kb, n0 = 32 * nb, ns = perm ? src_col32(n0) : n0;
#pragma unroll 8
    for (int i = 0; i < 32; ++i) { const int kk = 2 * i + (lane >> 5); scr[kk * 33 + (lane & 31)] = W[(size_t)(k0 + kk) * N + ns + (lane & 31)]; }
    asm volatile("s_waitcnt lgkmcnt(0)" ::: "memory");
    const int c = lane & 7;
#pragma unroll
    for (int j = 0; j < 4; ++j) { const int n = (lane >> 3) + 8 * j; const LAS float* s = scr + (8 * c) * 33 + n;
        u32x4 o; o.x = pk2(s[0 * 33], s[1 * 33]); o.y = pk2(s[2 * 33], s[3 * 33]); o.z = pk2(s[4 * 33], s[5 * 33]); o.w = pk2(s[6 * 33], s[7 * 33]);
        *(u32x4*)(WT + (size_t)(n0 + n) * K + k0 + 8 * c) = o; }
    asm volatile("s_waitcnt lgkmcnt(0)" ::: "memory");
}
__device__ __forceinline__ void rms_row_to_bf16(const float* xrow, const float* g, bf16* orow, int lane) {
    const f32x4* xr = (const f32x4*)xrow + lane; const f32x4* gr = (const f32x4*)g + lane;
    f32x4 v[4]; float s = 0.f;
#pragma unroll
    for (int j = 0; j < 4; ++j) { v[j] = xr[64 * j]; s += (v[j].x * v[j].x + v[j].y * v[j].y) + (v[j].z * v[j].z + v[j].w * v[j].w); }
    const float rstd = 1.0f / sqrtf(wave_sum(s) * (1.f / DM) + EPS_RMS);
    unsigned long long* o8 = (unsigned long long*)orow + lane;
#pragma unroll
    for (int j = 0; j < 4; ++j) { const f32x4 gg = gr[64 * j]; o8[64 * j] = (unsigned long long)pk2(v[j].x * rstd * gg.x, v[j].y * rstd * gg.y) | ((unsigned long long)pk2(v[j].z * rstd * gg.z, v[j].w * rstd * gg.w) << 32); }
}
__device__ __forceinline__ void rope_entry(int idx, float* rc, float* rs) {
    const int pos = idx >> 5, i = idx & 31;
    const double inv = exp2(-(double)i * (13.287712379549449 / 32.0));
    const double a = (double)pos * inv;
    const double k = rint(a * 0.15915494309189535);
    double r = fma(-k, 6.283185307179586, a); r = fma(-k, 2.4492935982947064e-16, r);
    const double r2 = r * r;
    double ts = r, ss = r, tc = 1.0, cs = 1.0;
#pragma unroll
    for (int n = 1; n <= 13; ++n) { ts *= -r2 / (double)((2 * n) * (2 * n + 1)); ss += ts; tc *= -r2 / (double)((2 * n - 1) * (2 * n)); cs += tc; }
    rc[idx] = (float)cs; rs[idx] = (float)ss;
}

struct Args { const float* in[16]; float* out; unsigned char* ws; int ph_lo, ph_hi; };
__global__ void __launch_bounds__(512, 2) fwd(Args args) {
    extern __shared__ __attribute__((aligned(16))) unsigned char lds[];
    const int tid = threadIdx.x, lane = tid & 63, wave = __builtin_amdgcn_readfirstlane(tid >> 6);
    const int G = gridDim.x, bx = blockIdx.x;
    unsigned char* ws = args.ws;
    const float* x = args.in[0]; const float* norm_g = args.in[1]; const float* w_in = args.in[2]; const float* conv_w = args.in[3]; const float* conv_b = args.in[4];
    const float* ln_g = args.in[5]; const float* ln_b = args.in[6]; const float* w_pw = args.in[7]; const float* b_pw = args.in[8];
    const float* lq1 = args.in[9]; const float* lk1 = args.in[10]; const float* lq2 = args.in[11]; const float* lk2 = args.in[12];
    const float* head_g = args.in[13]; const float* w_out = args.in[14]; const float* fin_g = args.in[15];
    float* out = args.out;
    unsigned* ctl = (unsigned*)(ws + WS_CTL);
    bf16* WinT = (bf16*)(ws + WS_WIN); bf16* WpwT = (bf16*)(ws + WS_WPW); bf16* WoutT = (bf16*)(ws + WS_WOUT);
    float* ropec = (float*)(ws + WS_ROPE); float* ropes = ropec + SEQ * 32;
    bf16* XN = (bf16*)(ws + WS_XN); bf16* Ub = (bf16*)(ws + WS_U); bf16* GAb = (bf16*)(ws + WS_GA); bf16* Qb = (bf16*)(ws + WS_Q); bf16* Kb = (bf16*)(ws + WS_K);
    bf16* Vb = (bf16*)(ws + WS_V); bf16* GBb = (bf16*)(ws + WS_GB); bf16* Yb = (bf16*)(ws + WS_Y); float* O1 = (float*)(ws + WS_O1);
    const int lo = args.ph_lo, hi = args.ph_hi;
#define IN(k) (lo <= (k) && (k) < hi)
#define BOTH(k) (IN(k) && IN((k) + 1))
#define GRID_SYNC() do { if constexpr (N_LAUNCHES == 1) { cg::this_grid().sync(); } } while (0)

    if (IN(0)) {
        LAS float* scr = (LAS float*)((LAS unsigned char*)lds + wave * 16384);
        const int gw = bx * 8 + wave, NGW = G * 8;
        constexpr int I_IN = (DM / 64) * (NIN / 32), I_PW = (CW / 64) * (CW / 32), I_OUT = (DM / 64) * (DM / 32);
        for (int it = gw; it < I_IN + I_PW + I_OUT; it += NGW) {
            int r = it;
            if (r < I_IN) { transpose_item(w_in, DM, NIN, WinT, true, scr, r, lane); continue; } r -= I_IN;
            if (r < I_PW) { transpose_item(w_pw, CW, CW, WpwT, false, scr, r, lane); continue; } r -= I_PW;
            transpose_item(w_out, DM, DM, WoutT, false, scr, r, lane);
        }
        for (int m = gw; m < M; m += NGW) rms_row_to_bf16(x + (size_t)m * DM, norm_g, XN + (size_t)m * DM, lane);
        for (int i = bx * 512 + tid; i < SEQ * 32; i += G * 512) rope_entry(i, ropec, ropes);
        if (BOTH(0)) GRID_SYNC();
    }
    if (IN(1)) {
        pg8::Gemm g{XN, WinT, M, NIN, DM}; pg8::StaticOrder S; S.init(M, NIN, G, bx);
        EpiIn E{Ub, GAb, Qb, Kb, Vb, GBb, ropec, ropes};
        pg8::gemm_phase<EpiIn, pg8::StaticOrder, true, true>((LAS unsigned char*)lds, g, S, E);
        if (BOTH(1)) GRID_SYNC();
    }
    if (IN(2)) {
        for (int un = bx; un < M / 32; un += G) conv_unit(un, Ub, GAb, conv_w, conv_b, ln_g, ln_b, WpwT, b_pw, Yb, (char*)lds);
        const float lam = __builtin_amdgcn_exp2f(wave_sum(lq1[lane] * lk1[lane]) * LOG2E) - __builtin_amdgcn_exp2f(wave_sum(lq2[lane] * lk2[lane]) * LOG2E) + 0.2f;
        for (int un = bx; un < BATCH * 4 * 8; un += G) att::unit(un, Qb, Kb, Vb, GBb, Yb, O1, head_g, lam, (char*)lds);
        if (BOTH(2)) GRID_SYNC();
    }
    if (IN(3)) {
        pg8::Gemm g{Yb, WoutT, M, DM, DM}; pg8::StaticOrder S; S.init(M, DM, G, bx);
        if constexpr (N_LAUNCHES == 1) {
            pg8::PanelStats st{(unsigned*)(ws + WS_XCH), ctl + CW_SEAM, ctl + CW_TMO, DM / 256, EPS_RMS, 0x700u};
            EpiOutFused E{x, out, fin_g, st};
            pg8::gemm_phase<EpiOutFused, pg8::StaticOrder, false, true>((LAS unsigned char*)lds, g, S, E);
        } else {
            EpiOutPlain E{x, out};
            pg8::gemm_phase<EpiOutPlain, pg8::StaticOrder, true, true>((LAS unsigned char*)lds, g, S, E);
        }
    }
    if (IN(4)) {
        const int gw = bx * 8 + wave, NGW = G * 8;
        for (int m = gw; m < M; m += NGW) {
            f32x4* xr = (f32x4*)(out + (size_t)m * DM) + lane; const f32x4* gr = (const f32x4*)fin_g + lane;
            f32x4 v[4]; float s = 0.f;
#pragma unroll
            for (int j = 0; j < 4; ++j) { v[j] = xr[64 * j]; s += (v[j].x * v[j].x + v[j].y * v[j].y) + (v[j].z * v[j].z + v[j].w * v[j].w); }
            const float rstd = 1.0f / sqrtf(wave_sum(s) * (1.f / DM) + EPS_RMS);
#pragma unroll
            for (int j = 0; j < 4; ++j) xr[64 * j] = v[j] * rstd * gr[64 * j];
        }
    }
#undef IN
#undef BOTH
#undef GRID_SYNC
}


#ifdef DBG_NAIVE_ATTN
__global__ void __launch_bounds__(512) dbg_attn(Args args) {
    extern __shared__ __attribute__((aligned(16))) unsigned char lds[];
    unsigned char* ws = args.ws; const int lane = threadIdx.x & 63;
    const float* lq1 = args.in[9]; const float* lk1 = args.in[10]; const float* lq2 = args.in[11]; const float* lk2 = args.in[12];
    const float lam = __builtin_amdgcn_exp2f(wave_sum(lq1[lane] * lk1[lane]) * LOG2E) - __builtin_amdgcn_exp2f(wave_sum(lq2[lane] * lk2[lane]) * LOG2E) + 0.2f;
    naive_attn(blockIdx.x, gridDim.x, (bf16*)(ws + WS_Q), (bf16*)(ws + WS_K), (bf16*)(ws + WS_V), (bf16*)(ws + WS_GB), (bf16*)(ws + WS_Y), args.in[13], lam, (char*)lds);
}
#endif

extern "C" void kernel_launch(void* const* d_in, const int* in_sizes, int n_in, void* d_out, int out_size, void* d_ws, size_t ws_size, hipStream_t stream) {
    static int grid = 0;
    if (grid == 0) {
        if (n_in != 16 || in_sizes[0] != M * DM || out_size != M * DM || ws_size < WS_END) { fprintf(stderr, "kernel_launch: unexpected shapes (n_in %d, in0 %d, out %d, ws %zu)\n", n_in, n_in > 0 ? in_sizes[0] : -1, out_size, ws_size); grid = -1; return; }
        int dev = 0, cus = 0, per_cu = 0;
        if (hipGetDevice(&dev) != hipSuccess || hipDeviceGetAttribute(&cus, hipDeviceAttributeMultiprocessorCount, dev) != hipSuccess) { grid = -1; return; }
        if (hipFuncSetAttribute((const void*)fwd, hipFuncAttributeMaxDynamicSharedMemorySize, LDS_BYTES) != hipSuccess) { fprintf(stderr, "kernel_launch: hipFuncSetAttribute failed\n"); grid = -1; return; }
        if (hipOccupancyMaxActiveBlocksPerMultiprocessor(&per_cu, (const void*)fwd, 512, LDS_BYTES) != hipSuccess || per_cu < 1) { fprintf(stderr, "kernel_launch: occupancy query says %d\n", per_cu); per_cu = 1; }
        (void)hipGetLastError();
        grid = cus * per_cu;
        if (grid != 256) fprintf(stderr, "kernel_launch: grid %d (expected 256)\n", grid);
    }
    if (grid < 0) return;
    (void)hipMemsetAsync((char*)d_ws + WS_CTL, 0, CTL_ZERO_BYTES, stream);
    Args a{};
    for (int i = 0; i < 16; ++i) a.in[i] = (const float*)d_in[i];
    a.out = (float*)d_out; a.ws = (unsigned char*)d_ws;
    if (N_LAUNCHES == 1) {
        a.ph_lo = 0; a.ph_hi = 4;
        void* kargs[] = {&a};
        const hipError_t e = hipLaunchCooperativeKernel((const void*)fwd, dim3(grid), dim3(512), kargs, LDS_BYTES, stream);
        if (e != hipSuccess) fprintf(stderr, "kernel_launch: cooperative launch failed: %s (grid %d)\n", hipGetErrorString(e), grid);
    } else {
        for (int p = 0; p < 5; ++p) { a.ph_lo = p; a.ph_hi = p + 1; hipLaunchKernelGGL(fwd, dim3(grid), dim3(512), LDS_BYTES, stream, a);
#ifdef DBG_NAIVE_ATTN
            if (p == 2) { (void)hipFuncSetAttribute((const void*)dbg_attn, hipFuncAttributeMaxDynamicSharedMemorySize, 65536); hipLaunchKernelGGL(dbg_attn, dim3(1024), dim3(512), 65536, stream, a); }
#endif
        }
    }
}
```
